# Optimizing an MI355X kernel written in HIP

```python
import jax, jax.numpy as jnp
from jax import lax
import numpy as np

D_MODEL = 1024
BATCH = 8
SEQ = 4096
DEPTH = 1

N_HEADS = 16
N_KV_HEADS = 4
HEAD_DIM = 64
Q_PER_KV = N_HEADS // N_KV_HEADS
WINDOW = 128
BLOCK = 128
ATTN_WIDTH = N_HEADS * HEAD_DIM
KV_WIDTH = N_KV_HEADS * HEAD_DIM
GMLP_WIDTH = 1024
GMLP_GROUPS = 8
GMLP_GROUP_DIM = GMLP_WIDTH // GMLP_GROUPS
GMLP_CHUNK = 128
N_EXPERT_GROUPS = 4
EXPERTS_PER_GROUP = 4
N_EXPERTS = N_EXPERT_GROUPS * EXPERTS_PER_GROUP
TOP_K = 2
D_EXPERT = 512

N_BRANCHES = 2
IN_WIDTH = ATTN_WIDTH + 2 * KV_WIDTH + 2 * GMLP_WIDTH + N_BRANCHES * D_MODEL
SPLITS = (ATTN_WIDTH,
          ATTN_WIDTH + KV_WIDTH,
          ATTN_WIDTH + 2 * KV_WIDTH,
          ATTN_WIDTH + 2 * KV_WIDTH + GMLP_WIDTH,
          ATTN_WIDTH + 2 * KV_WIDTH + 2 * GMLP_WIDTH)
EPS = 1e-6
NEG_INF = -1e30

kernel_name = "hybrid_swa_gmlp_hmoe_adaln"


def alibi_slopes(n_heads):
    return np.array([2.0 ** (-8.0 * (i + 1) / n_heads) for i in range(n_heads)], dtype=np.float32)


def rmsnorm(x, gain):
    xf = x.astype(jnp.float32)
    y = xf * lax.rsqrt(jnp.mean(xf * xf, axis=-1, keepdims=True) + EPS)
    return y.astype(x.dtype) * gain


def layernorm(x, gain, bias):
    xf = x.astype(jnp.float32)
    mu = jnp.mean(xf, axis=-1, keepdims=True)
    var = jnp.mean(jnp.square(xf - mu), axis=-1, keepdims=True)
    y = (xf - mu) * lax.rsqrt(var + EPS)
    return y.astype(x.dtype) * gain + bias


def modulate(h, shift, scale):
    return h * (1.0 + scale[:, None, :]) + shift[:, None, :]


def sliding_window_attention(q, k, v, q_gain, k_gain, sinks):
    B, S = q.shape[0], q.shape[1]
    nb = S // BLOCK
    q = rmsnorm(q, q_gain)
    k = rmsnorm(k, k_gain)
    qb = q.reshape(B, nb, BLOCK, N_KV_HEADS, Q_PER_KV, HEAD_DIM)
    kb = k.reshape(B, nb, BLOCK, N_KV_HEADS, HEAD_DIM)
    vb = v.reshape(B, nb, BLOCK, N_KV_HEADS, HEAD_DIM)
    pad = ((0, 0), (1, 0), (0, 0), (0, 0), (0, 0))
    k_cat = jnp.concatenate([jnp.pad(kb, pad)[:, :-1], kb], axis=2)
    v_cat = jnp.concatenate([jnp.pad(vb, pad)[:, :-1], vb], axis=2)
    scores = jnp.einsum('bnqkgd,bnskd->bnkgqs', qb, k_cat).astype(jnp.float32) * (HEAD_DIM ** -0.5)
    q_idx = jnp.arange(BLOCK)[:, None] + BLOCK
    k_idx = jnp.arange(2 * BLOCK)[None, :]
    dist = q_idx - k_idx
    in_window = (dist >= 0) & (dist < WINDOW)
    blk = jnp.arange(nb)[:, None, None]
    valid = in_window[None] & ((blk > 0) | (k_idx >= BLOCK)[None])
    slopes = jnp.asarray(alibi_slopes(N_HEADS)).reshape(N_KV_HEADS, Q_PER_KV)
    scores = scores - slopes[None, None, :, :, None, None] * dist.astype(jnp.float32)[None, None, None, None]
    scores = jnp.where(valid[None, :, None, None], scores, NEG_INF)
    sink = sinks.astype(jnp.float32).reshape(N_KV_HEADS, Q_PER_KV)[None, None, :, :, None, None]
    sink = jnp.broadcast_to(sink, scores.shape[:-1] + (1,))
    probs = jax.nn.softmax(jnp.concatenate([scores, sink], axis=-1), axis=-1)[..., :-1]
    out = jnp.einsum('bnkgqs,bnskd->bnqkgd', probs.astype(v_cat.dtype), v_cat)
    return out.reshape(B, S, ATTN_WIDTH)


def chunked_spatial_gating(u, vg, norm_gain, norm_bias, w_spatial, b_spatial):
    B, S = u.shape[0], u.shape[1]
    nc = S // GMLP_CHUNK
    vg = layernorm(vg, norm_gain, norm_bias)
    vc = vg.reshape(B, nc, GMLP_CHUNK, GMLP_GROUPS, GMLP_GROUP_DIM)
    tril = jnp.tril(jnp.ones((GMLP_CHUNK, GMLP_CHUNK), dtype=bool))
    w = jnp.where(tril[None], w_spatial, 0.0)
    mixed = jnp.einsum('gts,bnsgc->bntgc', w, vc) + b_spatial.T[None, None, :, :, None]
    return u * mixed.reshape(B, S, GMLP_WIDTH)


def hierarchical_moe(h, w_group_router, b_group_router, w_expert_router, b_expert_router, w_gate, w_up, w_down):
    B, S, D = h.shape
    hf = h.reshape(B * S, D)
    g_logits = (hf @ w_group_router).astype(jnp.float32) + b_group_router
    g_prob = jax.nn.softmax(g_logits, axis=-1)
    g_idx = jnp.argmax(g_logits, axis=-1)
    g_weight = jnp.take_along_axis(g_prob, g_idx[:, None], axis=-1)
    e_logits = ((hf @ w_expert_router).astype(jnp.float32) + b_expert_router).reshape(-1, N_EXPERT_GROUPS, EXPERTS_PER_GROUP)
    e_in_group = jnp.take_along_axis(e_logits, g_idx[:, None, None], axis=1)[:, 0]
    top_vals, top_idx = lax.top_k(e_in_group, TOP_K)
    top_w = jax.nn.softmax(top_vals, axis=-1) * g_weight
    w_in_group = jnp.sum(jax.nn.one_hot(top_idx, EXPERTS_PER_GROUP, dtype=jnp.float32) * top_w[..., None], axis=1)
    combine = jax.nn.one_hot(g_idx, N_EXPERT_GROUPS, dtype=jnp.float32)[:, :, None] * w_in_group[:, None, :]
    combine = combine.astype(hf.dtype)
    out = jnp.zeros_like(hf)
    for gi in range(N_EXPERT_GROUPS):
        a = jnp.einsum('td,edf->tef', hf, w_gate[gi])
        b = jnp.einsum('td,edf->tef', hf, w_up[gi])
        hid = jax.nn.silu(a) * b * combine[:, gi, :, None]
        out = out + jnp.einsum('tef,efd->td', hid, w_down[gi])
    return out.reshape(B, S, D)


def setup_inputs(seed: int = 0) -> dict:
    key = jax.random.key(seed)
    ks = jax.random.split(key, 25)
    L, D = DEPTH, D_MODEL

    def nrm(k, shape, s):
        return jax.random.normal(k, shape, jnp.float32) * s

    return {
        "x": nrm(ks[0], (BATCH, SEQ, D), 1.0),
        "c": nrm(ks[1], (BATCH, D), 1.0),
        "w_ada": nrm(ks[2], (L, D, 6 * D), 0.2 * D ** -0.5),
        "b_ada": nrm(ks[3], (L, 6 * D), 0.02),
        "norm1_gain": 1.0 + nrm(ks[4], (L, D), 0.02),
        "w_in": nrm(ks[5], (L, D, IN_WIDTH), D ** -0.5),
        "b_branch_gate": nrm(ks[6], (L, N_BRANCHES * D), 0.02),
        "q_norm_gain": 1.0 + nrm(ks[7], (L, HEAD_DIM), 0.02),
        "k_norm_gain": 1.0 + nrm(ks[8], (L, HEAD_DIM), 0.02),
        "attn_sinks": nrm(ks[9], (L, N_HEADS), 0.5),
        "gmlp_norm_gain": 1.0 + nrm(ks[10], (L, GMLP_WIDTH), 0.02),
        "gmlp_norm_bias": nrm(ks[11], (L, GMLP_WIDTH), 0.02),
        "gmlp_w_spatial": nrm(ks[12], (L, GMLP_GROUPS, GMLP_CHUNK, GMLP_CHUNK), 0.5 * GMLP_CHUNK ** -0.5),
        "gmlp_b_spatial": 1.0 + nrm(ks[13], (L, GMLP_GROUPS, GMLP_CHUNK), 0.02),
        "w_o_attn": nrm(ks[14], (L, ATTN_WIDTH, D), ATTN_WIDTH ** -0.5),
        "w_o_gmlp": nrm(ks[15], (L, GMLP_WIDTH, D), GMLP_WIDTH ** -0.5),
        "w_out": nrm(ks[16], (L, D, D), D ** -0.5),
        "norm2_gain": 1.0 + nrm(ks[17], (L, D), 0.02),
        "w_group_router": nrm(ks[18], (L, D, N_EXPERT_GROUPS), D ** -0.5),
        "b_group_router": nrm(ks[19], (L, N_EXPERT_GROUPS), 0.01),
        "w_expert_router": nrm(ks[20], (L, D, N_EXPERTS), D ** -0.5),
        "b_expert_router": nrm(ks[21], (L, N_EXPERTS), 0.01),
        "w_expert_gate": nrm(ks[22], (L, N_EXPERT_GROUPS, EXPERTS_PER_GROUP, D, D_EXPERT), D ** -0.5),
        "w_expert_up": nrm(ks[23], (L, N_EXPERT_GROUPS, EXPERTS_PER_GROUP, D, D_EXPERT), D ** -0.5),
        "w_expert_down": nrm(ks[24], (L, N_EXPERT_GROUPS, EXPERTS_PER_GROUP, D_EXPERT, D), D_EXPERT ** -0.5),
    }


def reference(x, c, w_ada, b_ada, norm1_gain, w_in, b_branch_gate, q_norm_gain, k_norm_gain, attn_sinks,
              gmlp_norm_gain, gmlp_norm_bias, gmlp_w_spatial, gmlp_b_spatial, w_o_attn, w_o_gmlp, w_out,
              norm2_gain, w_group_router, b_group_router, w_expert_router, b_expert_router,
              w_expert_gate, w_expert_up, w_expert_down):
    B, S, _ = x.shape
    c_act = jax.nn.silu(c)
    for l in range(DEPTH):
        mod = c_act @ w_ada[l] + b_ada[l]
        shift1, scale1, gate1, shift2, scale2, gate2 = jnp.split(mod, 6, axis=-1)

        h = modulate(rmsnorm(x, norm1_gain[l]), shift1, scale1)
        proj = h @ w_in[l]
        q, k, v, u, vg, gate_logits = jnp.split(proj, SPLITS, axis=-1)
        q = q.reshape(B, S, N_HEADS, HEAD_DIM)
        k = k.reshape(B, S, N_KV_HEADS, HEAD_DIM)
        v = v.reshape(B, S, N_KV_HEADS, HEAD_DIM)
        y_attn = sliding_window_attention(q, k, v, q_norm_gain[l], k_norm_gain[l], attn_sinks[l])
        u = jax.nn.gelu(u, approximate=False)
        vg = jax.nn.gelu(vg, approximate=False)
        y_gmlp = chunked_spatial_gating(u, vg, gmlp_norm_gain[l], gmlp_norm_bias[l], gmlp_w_spatial[l], gmlp_b_spatial[l])
        gates = jax.nn.sigmoid(gate_logits + b_branch_gate[l])
        g_attn, g_gmlp = jnp.split(gates, N_BRANCHES, axis=-1)
        merged = g_attn * (y_attn @ w_o_attn[l]) + g_gmlp * (y_gmlp @ w_o_gmlp[l])
        x = x + gate1[:, None, :] * (merged @ w_out[l])

        h2 = modulate(rmsnorm(x, norm2_gain[l]), shift2, scale2)
        y_moe = hierarchical_moe(h2, w_group_router[l], b_group_router[l], w_expert_router[l], b_expert_router[l],
                                 w_expert_gate[l], w_expert_up[l], w_expert_down[l])
        x = x + gate2[:, None, :] * y_moe
    return x
```

```cpp
#include <hip/hip_runtime.h>
#include <cstdio>
#include <cstdint>

#define LAS __attribute__((address_space(3)))
#define GAS __attribute__((address_space(1)))
typedef unsigned short bf16_t;
typedef short bf16x8 __attribute__((ext_vector_type(8)));
typedef short s16x4 __attribute__((ext_vector_type(4)));
typedef float f32x2 __attribute__((ext_vector_type(2)));
typedef float f32x4 __attribute__((ext_vector_type(4)));
typedef float f32x16 __attribute__((ext_vector_type(16)));
typedef unsigned u32x2 __attribute__((ext_vector_type(2)));
typedef unsigned u32x4 __attribute__((ext_vector_type(4)));
typedef int i32x4 __attribute__((ext_vector_type(4)));
typedef __bf16 bf16x2_t __attribute__((ext_vector_type(2)));

#ifndef MK_N_LAUNCHES
#define MK_N_LAUNCHES 9


#endif
constexpr int N_PHASES = 9;
constexpr int N_LAUNCHES = MK_N_LAUNCHES;
static_assert(N_LAUNCHES == 1 || N_LAUNCHES == N_PHASES, "MK_N_LAUNCHES is 1 or 9");

constexpr int D = 1024, BATCH = 8, SEQ = 4096, T = BATCH * SEQ;
constexpr int NH = 16, NKV = 4, HD = 64, BLK = 128, NBLK = SEQ / BLK;
constexpr int GW = 1024, NGG = 8, GD = 128;
constexpr int NE = 16, DE = 512, NBUCKET = 24;
constexpr int INW = 5632;
constexpr float EPS = 1e-6f;
constexpr float LOG2E = 1.4426950408889634f;
constexpr int NWAVES = 8, NTHREADS = 512;
#ifndef MOE_RC
#define MOE_RC 256
#endif

constexpr size_t MiB = 1u << 20;
constexpr size_t WS_CTL = 0, CTL_ZERO_BYTES = 1 * MiB;
constexpr size_t WS_MOD = 1 * MiB;
constexpr size_t WS_WTRIL = 1 * MiB + 512 * 1024;
constexpr size_t WS_WIN = 2 * MiB;
constexpr size_t WS_WOA = 14 * MiB, WS_WOG = 16 * MiB, WS_WOUT = 18 * MiB;
constexpr size_t WS_WGU = 20 * MiB;
constexpr size_t WS_WDN = 52 * MiB;
constexpr size_t WS_LNP = 68 * MiB;
constexpr size_t WS_SSP = 72 * MiB;
constexpr size_t WS_TOK = 74 * MiB;
constexpr size_t WS_H = 88 * MiB;
constexpr size_t WS_Q = 152 * MiB;
constexpr size_t WS_K = 216 * MiB, WS_V = 232 * MiB;
constexpr size_t WS_U = 248 * MiB;
constexpr size_t WS_VG = 312 * MiB;
constexpr size_t WS_GA = 376 * MiB, WS_GG = 440 * MiB;
constexpr size_t WS_END = 504 * MiB;
constexpr size_t WS_HID = WS_Q;
constexpr int CW_TMO = 0, CW_CODE = 1;
constexpr int CW_CNT = 64;
constexpr int CW_BAR = 4096;

constexpr int RING_OFF = 0, RING_BYTES = 131072;
constexpr int LDSCTL_OFF = RING_BYTES, MISC_OFF = LDSCTL_OFF + 320, TAB_OFF = MISC_OFF + 128;
constexpr int LDS_BYTES = 147456;

#define RLX_AGENT __ATOMIC_RELAXED, __HIP_MEMORY_SCOPE_AGENT
#define LDS_WAIT() asm volatile("s_waitcnt lgkmcnt(0)" ::: "memory")
#define VM_WAIT() asm volatile("s_waitcnt vmcnt(0)" ::: "memory")

__device__ __forceinline__ unsigned cvtpk(float lo, float hi) { f32x2 v = {lo, hi}; bf16x2_t b = __builtin_convertvector(v, bf16x2_t); return __builtin_bit_cast(unsigned, b); }
__device__ __forceinline__ float bf_lo(unsigned w) { return __uint_as_float(w << 16); }
__device__ __forceinline__ float bf_hi(unsigned w) { return __uint_as_float(w & 0xffff0000u); }
__device__ __forceinline__ float wave_sum(float v) {
#pragma unroll
    for (int o = 1; o < 64; o <<= 1) v += __shfl_xor(v, o);
    return v;
}
__device__ __forceinline__ float fast_exp2(float x) { return __builtin_amdgcn_exp2f(x); }
__device__ __forceinline__ float fast_rcp(float x) { return __builtin_amdgcn_rcpf(x); }
__device__ __forceinline__ f32x2 gelu_pk(f32x2 v) {
    const f32x2 av = __builtin_elementwise_abs(v), d = av * 0.2316418882f + 1.0f;
    f32x2 t; t.x = __builtin_amdgcn_rcpf(d.x); t.y = __builtin_amdgcn_rcpf(d.y);
    f32x2 q = t * 0.5307027145f + (-0.7265760135f); q = q * t + 0.7107068705f; q = q * t + (-0.142248368f); q = q * t + 0.127414796f; q = q * t;
    const f32x2 s = (v * v) * (-0.72134752044f);
    f32x2 e; e.x = __builtin_amdgcn_exp2f(s.x); e.y = __builtin_amdgcn_exp2f(s.y);
    const f32x2 m = v * (q * e), r = v - m;
    f32x2 o; o.x = v.x < 0.f ? m.x : r.x; o.y = v.y < 0.f ? m.y : r.y; return o;
}
__device__ __forceinline__ f32x4 gelu4(f32x4 v) { f32x2 a = gelu_pk((f32x2){v[0], v[1]}), b = gelu_pk((f32x2){v[2], v[3]}); return (f32x4){a.x, a.y, b.x, b.y}; }
__device__ __forceinline__ float sigmoidf_(float x) { return fast_rcp(1.0f + fast_exp2(-x * LOG2E)); }

namespace pg8 {
constexpr int BM = 256, BK = 64, HALF = 128, HTB = HALF * BK * 2, STAGE_BYTES = 8 * HTB, NXCD = 8, WGM = 8;
constexpr int KD = 1024, NT = KD / BK;
__host__ __device__ __forceinline__ int lds_byte(int r, int c) { const int st = (r >> 4) * 2 + (c >> 5), rr = r & 15, cc = c & 31, ob = rr * 64 + cc * 2; return st * 1024 + (ob ^ (((ob >> 9) & 1) << 5)); }
__host__ __device__ __forceinline__ void stage_rc(int b, int& R, int& C) { const int st = b / 1024, sb = b % 1024, swz = sb ^ (((sb >> 9) & 1) << 5); R = (st >> 1) * 16 + swz / 64; C = (st & 1) * 32 + (swz % 64) / 2; }
__host__ __device__ __forceinline__ int perm32(int rho) { const int n = rho >> 4, i = rho & 15; return 8 * (i >> 2) + 4 * n + (i & 3); }

struct Unit { int pm, pn, x0, x1, x2; };

__device__ __forceinline__ void tile_of(int L, int nM, int nN, int& pm, int& pn) {
    const int nwg = nM * nN; int wgid = L;
    { const int q = nwg / NXCD, r = nwg % NXCD, xcd = wgid % NXCD, off = wgid / NXCD; wgid = (xcd < r ? xcd * (q + 1) : r * (q + 1) + (xcd - r) * q) + off; }
    const int nig = WGM * nN, gid = wgid / nig, fm = gid * WGM, gsz = (nM - fm) < WGM ? (nM - fm) : WGM;
    pm = fm + ((wgid % nig) % gsz); pn = (wgid % nig) / gsz;
}

template <class Epi, class Sched, bool ALIGN_EPI>
__device__ __forceinline__ void gemm_phase(LAS unsigned char* lds, const Sched& S, const Epi& E) {
    const int tid = threadIdx.x, wid = __builtin_amdgcn_readfirstlane(tid >> 6), lane = tid & 63, wr = wid >> 2, wc = wid & 3, fr = lane & 15, fq = lane >> 4;
    constexpr int K = KD, nt = NT, LDB = Sched::LDB;
    int Rr[2], Cc[2]; unsigned voffA[2][2], voffB[2];
#pragma unroll
    for (int i = 0; i < 2; ++i) { int R, C; stage_rc(tid * 16 + i * 8192, R, C); Rr[i] = R; Cc[i] = C; const int Rb = Epi::PERM ? ((R & ~31) + perm32(R & 31)) : R;
        voffA[0][i] = (unsigned)(R * K + C) * 2u; voffA[1][i] = (unsigned)((R + HALF) * K + C) * 2u; voffB[i] = (unsigned)(Rb * LDB + C) * 2u; }
    const size_t kstep = (size_t)(BK * 2);
    const size_t hstepB = (size_t)HALF * LDB * 2;
    const unsigned ldsw = (unsigned)wid * 1024u;
    const int aoff = lds_byte(wr * 64 + fr, fq * 8), boff = lds_byte(wc * 32 + fr, fq * 8);
#define PG8_SA(b, h) (((b) * 2 + (h)) * HTB)
#define PG8_SB(b, h) ((4 + (b) * 2 + (h)) * HTB)
#define PG8_STAGE(bufoff, gbase, voff) do { _Pragma("unroll") for (int _i = 0; _i < 2; ++_i) \
        __builtin_amdgcn_global_load_lds((const unsigned*)((const char*)(gbase) + (voff)[_i]), (LAS unsigned*)(lds + (bufoff) + ldsw + _i * 8192), 16, 0, 0); } while (0)
#define PG8_LDA(dst, b, h) do { _Pragma("unroll") for (int m = 0; m < 4; ++m) _Pragma("unroll") for (int k = 0; k < 2; ++k) dst[m][k] = *(const LAS bf16x8*)(lds + PG8_SA(b, h) + aoff + m * 2048 + k * 1024); } while (0)
#define PG8_LDB(dst, b, h) do { _Pragma("unroll") for (int n = 0; n < 2; ++n) _Pragma("unroll") for (int k = 0; k < 2; ++k) dst[n][k] = *(const LAS bf16x8*)(lds + PG8_SB(b, h) + boff + n * 2048 + k * 1024); } while (0)
#define PG8_MMA(ai, bj, At, Bt) do { __builtin_amdgcn_s_setprio(1); _Pragma("unroll") for (int m = 0; m < 4; ++m) _Pragma("unroll") for (int n = 0; n < 2; ++n) _Pragma("unroll") for (int k = 0; k < 2; ++k) \
        acc[ai][bj][m][n] = __builtin_amdgcn_mfma_f32_16x16x32_bf16(Bt[n][k], At[m][k], acc[ai][bj][m][n], 0, 0, 0); __builtin_amdgcn_s_setprio(0); } while (0)
#define PG8_WAIT_V(n) asm volatile("s_waitcnt vmcnt(" #n ")" ::: "memory")
#define PG8_WAIT_L(n) asm volatile("s_waitcnt lgkmcnt(" #n ")" ::: "memory")
#define PG8_BAR __builtin_amdgcn_s_barrier()
#define PG8_SCHED __builtin_amdgcn_sched_barrier(0)
    Unit cur, nxt; int ui = 0;
    if (!S.next(0, cur)) return;
    f32x4 acc[2][2][4][2];
#pragma unroll
    for (int a = 0; a < 2; ++a)
#pragma unroll
        for (int b = 0; b < 2; ++b)
#pragma unroll
            for (int m = 0; m < 4; ++m)
#pragma unroll
                for (int n = 0; n < 2; ++n) acc[a][b][m][n] = (f32x4){0.f, 0.f, 0.f, 0.f};
    bf16x8 At[4][2], B0[2][2], B1[2][2];
    const char* cA = S.a_base(cur);
    const char* cB0 = S.b_base(cur, 0);
    const char* cB1 = Sched::BSPLIT ? S.b_base(cur, 1) - (size_t)(nt / 2) * kstep : cB0;
    if constexpr (Sched::GATHER) S.a_off(cur, Rr, Cc, voffA);
    unsigned nvA[2][2] = {{0u, 0u}, {0u, 0u}};
    PG8_STAGE(PG8_SB(0, 0), cB0, voffB); PG8_STAGE(PG8_SB(0, 1), cB0 + hstepB, voffB); PG8_STAGE(PG8_SA(0, 0), cA, voffA[0]); PG8_STAGE(PG8_SA(0, 1), cA, voffA[1]);
    if (wr == 1) PG8_BAR;
    PG8_WAIT_V(2); PG8_BAR;
    PG8_STAGE(PG8_SB(1, 0), cB0 + kstep, voffB); PG8_STAGE(PG8_SA(1, 0), cA + kstep, voffA[0]); PG8_STAGE(PG8_SB(1, 1), cB0 + hstepB + kstep, voffB);
    PG8_WAIT_V(6); PG8_BAR;
    for (;;) {
        const bool has_next = S.next(ui + 1, nxt);
        const char* nA = has_next ? S.a_base(nxt) : cA; const char* nB0 = has_next ? S.b_base(nxt, 0) : cB0;
        const char* nB1 = Sched::BSPLIT ? (has_next ? S.b_base(nxt, 1) - (size_t)(nt / 2) * kstep : cB1) : nB0;
        if constexpr (Sched::GATHER) { if (has_next) S.a_off(nxt, Rr, Cc, nvA); else {
#pragma unroll
            for (int h = 0; h < 2; ++h)
#pragma unroll
                for (int i = 0; i < 2; ++i) nvA[h][i] = voffA[h][i]; } }
        for (int t = 0; t < nt; t += 2) {
            const bool last = (t == nt - 2);
            const char* a1 = cA + (size_t)(t + 1) * kstep;
            const char* bsel = (Sched::BSPLIT && (t + 2) >= nt / 2) ? cB1 : cB0;
            const char* a2 = last ? nA : cA + (size_t)(t + 2) * kstep; const char* b2 = last ? nB0 : bsel + (size_t)(t + 2) * kstep;
            const char* a3 = a2 + kstep; const char* b3 = b2 + kstep;
            unsigned va2[2][2];
#pragma unroll
            for (int h = 0; h < 2; ++h)
#pragma unroll
                for (int i = 0; i < 2; ++i) va2[h][i] = voffA[h][i];
            if constexpr (Sched::GATHER) { if (last) { asm volatile("" : "+v"(nvA[0][0]), "+v"(nvA[0][1]), "+v"(nvA[1][0]), "+v"(nvA[1][1]));
#pragma unroll
                for (int h = 0; h < 2; ++h)
#pragma unroll
                    for (int i = 0; i < 2; ++i) va2[h][i] = nvA[h][i]; } }
            PG8_LDB(B0, 0, 0); PG8_LDB(B1, 0, 1); PG8_SCHED; PG8_LDA(At, 0, 0); PG8_STAGE(PG8_SA(1, 1), a1, voffA[1]);
            PG8_WAIT_V(8); PG8_WAIT_L(0); PG8_BAR; PG8_MMA(0, 0, At, B0); PG8_MMA(0, 1, At, B1); PG8_BAR; PG8_SCHED;
            PG8_LDA(At, 0, 1); PG8_STAGE(PG8_SB(0, 0), b2, voffB); PG8_STAGE(PG8_SB(0, 1), b2 + hstepB, voffB); PG8_STAGE(PG8_SA(0, 0), a2, va2[0]);
            PG8_WAIT_V(8); PG8_WAIT_L(0); PG8_BAR; PG8_MMA(1, 0, At, B0); PG8_MMA(1, 1, At, B1); PG8_BAR; PG8_SCHED;
            PG8_LDB(B0, 1, 0); PG8_LDB(B1, 1, 1); PG8_SCHED; PG8_LDA(At, 1, 0); PG8_STAGE(PG8_SA(0, 1), a2, va2[1]);
            PG8_WAIT_V(8); PG8_WAIT_L(0); PG8_BAR; PG8_MMA(0, 0, At, B0); PG8_MMA(0, 1, At, B1); PG8_BAR; PG8_SCHED;
            PG8_LDA(At, 1, 1); PG8_STAGE(PG8_SB(1, 0), b3, voffB); PG8_STAGE(PG8_SB(1, 1), b3 + hstepB, voffB); PG8_STAGE(PG8_SA(1, 0), a3, va2[0]);
            PG8_WAIT_V(8); PG8_WAIT_L(0); PG8_BAR; PG8_MMA(1, 0, At, B0); PG8_MMA(1, 1, At, B1); PG8_BAR; PG8_SCHED;
        }
        if constexpr (ALIGN_EPI) { if (wr == 0) PG8_BAR; }
        E(acc, cur, wr, wc, fr, fq);
        if (!has_next) break;
#pragma unroll
        for (int a = 0; a < 2; ++a)
#pragma unroll
            for (int b = 0; b < 2; ++b)
#pragma unroll
                for (int m = 0; m < 4; ++m)
#pragma unroll
                    for (int n = 0; n < 2; ++n) acc[a][b][m][n] = (f32x4){0.f, 0.f, 0.f, 0.f};
        cur = nxt; cA = nA; cB0 = nB0; cB1 = nB1; ++ui;
        if constexpr (Sched::GATHER) {
#pragma unroll
            for (int h = 0; h < 2; ++h)
#pragma unroll
                for (int i = 0; i < 2; ++i) voffA[h][i] = nvA[h][i]; }
        if constexpr (ALIGN_EPI) { if (wr == 1) PG8_BAR; }
    }
    PG8_WAIT_V(0);
    if constexpr (!ALIGN_EPI) { if (wr == 0) PG8_BAR; }
    PG8_BAR;
#undef PG8_SA
#undef PG8_SB
#undef PG8_STAGE
#undef PG8_LDA
#undef PG8_LDB
#undef PG8_MMA
#undef PG8_WAIT_V
#undef PG8_WAIT_L
#undef PG8_BAR
#undef PG8_SCHED
}
}
using pg8::Unit;

#define XB_TMO      128
#define XB_XCNT(j)  (256  + 64 * (j))
#define XB_XSUB(j)  (1280 + 64 * (j))
#define XB_XGEN(j)  (2304 + 64 * (j))
#define XB_TOP      3328
#define XB_TOPGEN   3392
#define XCD_BAR_WORDS 3456
#define XB_SPIN_CAP (1u << 18)
__device__ __forceinline__ unsigned xb_ld(unsigned* p)              { return __hip_atomic_load(p, __ATOMIC_RELAXED, __HIP_MEMORY_SCOPE_AGENT); }
__device__ __forceinline__ unsigned xb_add(unsigned* p, unsigned v) { return __hip_atomic_fetch_add(p, v, __ATOMIC_RELAXED, __HIP_MEMORY_SCOPE_AGENT); }
__device__ __forceinline__ unsigned xb_xcc_id() { return (unsigned)__builtin_amdgcn_s_getreg((3 << 11) | 20) & 0xFu; }
#define XB_SPIN(cond, bar) do { unsigned _sp = 0; while (cond) { __builtin_amdgcn_s_sleep(1); \
    if ((++_sp & 255u) == 0u) { if (xb_ld(&(bar)[XB_TMO])) break; if (_sp > XB_SPIN_CAP) { atomicAdd(&(bar)[XB_TMO], 1u); break; } } } } while (0)
struct XcdBarrier { unsigned* bar; unsigned x; volatile LAS unsigned* st; };
__device__ __forceinline__ XcdBarrier xcd_barrier_post(unsigned* bar, volatile LAS unsigned* st) {
    XcdBarrier b; b.bar = bar; b.x = xb_xcc_id(); b.st = st;
    if (threadIdx.x == 0) (void)xb_add(&bar[XB_XCNT(b.x)], 1u);
    return b;
}
__device__ __forceinline__ void xcd_barrier_complete(unsigned* bar, unsigned x, unsigned& nloc, unsigned& nx) {
    const unsigned G = gridDim.x * gridDim.y * gridDim.z;
    unsigned sum, cnt, mine, sp = 0u;
    for (;;) {
        sum = 0u; cnt = 0u; mine = 0u;
#pragma unroll
        for (unsigned j = 0; j < 16; ++j) { const unsigned c = xb_ld(&bar[XB_XCNT(j)]); sum += c; cnt += (c > 0u) ? 1u : 0u; mine = (j == x) ? c : mine; }
        if (sum == G) break;
        __builtin_amdgcn_s_sleep(1);
        if ((++sp & 255u) == 0u) { if (xb_ld(&bar[XB_TMO])) break; if (sp > XB_SPIN_CAP) { atomicAdd(&bar[XB_TMO], 1u); break; } }
    }
    nloc = mine > 0u ? mine : 1u; nx = cnt > 0u ? cnt : 1u;
}
__device__ __forceinline__ void xcd_barrier(const XcdBarrier& b) {
    asm volatile("s_waitcnt vmcnt(0)" ::: "memory");
    __syncthreads();
    if (threadIdx.x == 0) {
        unsigned* bar = b.bar;
        __builtin_amdgcn_s_waitcnt(0);
        unsigned nloc = b.st[0], nx = b.st[1];
        if (nloc == 0u) { xcd_barrier_complete(bar, b.x, nloc, nx); b.st[0] = nloc; b.st[1] = nx; }
        const unsigned old = xb_add(&bar[XB_XSUB(b.x)], 1u);
        const unsigned gen = old / nloc;
        if (old + 1u == (gen + 1u) * nloc) {
            __builtin_amdgcn_fence(__ATOMIC_RELEASE, "agent");
            asm volatile("s_waitcnt vmcnt(0)" ::: "memory");
            const unsigned og = xb_add(&bar[XB_TOP], 1u);
            const unsigned tg = og / nx;
            if (og + 1u == (tg + 1u) * nx) xb_add(&bar[XB_TOPGEN], 1u);
            else XB_SPIN(xb_ld(&bar[XB_TOPGEN]) == tg, bar);
            __builtin_amdgcn_fence(__ATOMIC_ACQUIRE, "agent");
            xb_add(&bar[XB_XGEN(b.x)], 1u);
            asm volatile("s_waitcnt vmcnt(0)" ::: "memory");
        } else {
            XB_SPIN(xb_ld(&bar[XB_XGEN(b.x)]) == gen, bar);
            __builtin_amdgcn_fence(__ATOMIC_ACQUIRE, "agent");
            asm volatile("s_waitcnt vmcnt(0)" ::: "memory");
        }
    }
    __syncthreads();
}

struct DenseSched {
    static constexpr bool GATHER = false, BSPLIT = false; static constexpr int LDB = 1024;
    const bf16_t* A; const bf16_t* Bt; int nM, nN, G, c;
    __device__ __forceinline__ bool next(int i, Unit& u) const { const long L = (long)i * G + c; if (L >= (long)nM * nN) return false; pg8::tile_of((int)L, nM, nN, u.pm, u.pn); u.x0 = 0; u.x1 = 0; u.x2 = 256; return true; }
    __device__ __forceinline__ const char* a_base(const Unit& u) const { return (const char*)A + (size_t)u.pm * 256 * 1024 * 2; }
    __device__ __forceinline__ const char* b_base(const Unit& u, int) const { return (const char*)Bt + (size_t)u.pn * 256 * 1024 * 2; }
    __device__ __forceinline__ void a_off(const Unit&, const int (&)[2], const int (&)[2], unsigned (&)[2][2]) const {}
};
struct MergeSched {
    static constexpr bool GATHER = false, BSPLIT = false; static constexpr int LDB = 1024;
    const bf16_t* A0; const bf16_t* A1; const bf16_t* B0; const bf16_t* B1; int nM, nN, G, c;
    __device__ __forceinline__ bool next(int i, Unit& u) const { const long L = (long)(i >> 1) * G + c; if (L >= (long)nM * nN) return false; pg8::tile_of((int)L, nM, nN, u.pm, u.pn); u.x0 = i & 1; u.x1 = 0; u.x2 = 256; return true; }
    __device__ __forceinline__ const char* a_base(const Unit& u) const { return (const char*)(u.x0 ? A1 : A0) + (size_t)u.pm * 256 * 1024 * 2; }
    __device__ __forceinline__ const char* b_base(const Unit& u, int) const { return (const char*)(u.x0 ? B1 : B0) + (size_t)u.pn * 256 * 1024 * 2; }
    __device__ __forceinline__ void a_off(const Unit&, const int (&)[2], const int (&)[2], unsigned (&)[2][2]) const {}
};
__device__ __forceinline__ void pair_of(int p, int& elo, int& ehi) { elo = p < 3 ? 0 : (p < 5 ? 1 : 2); ehi = p < 3 ? p + 1 : (p < 5 ? p - 1 : 3); }
template <bool UP> struct MoeSched {
    static constexpr bool GATHER = UP, BSPLIT = !UP; static constexpr int LDB = UP ? 1024 : 512;
    const bf16_t* A; const bf16_t* W; const i32x4* tokw; const LAS int* cnt; const LAS int* tp; int G, c;
    static constexpr int NN = UP ? 8 : 4;
    __device__ __forceinline__ bool next(int i, Unit& u) const {
        const long L = (long)i * G + c; const int ntile = tp[NBUCKET]; if (L >= (long)ntile * NN) return false;
        const int st = (int)(L / NN), pn = (int)(L % NN); int b = 0;
#pragma unroll
        for (int k = 1; k < NBUCKET; ++k) b += (st >= tp[k]) ? 1 : 0;
        u.pm = st; u.pn = pn; u.x0 = b; u.x1 = st - tp[b]; const int rem = cnt[b] - MOE_RC * u.x1; u.x2 = rem < MOE_RC ? rem : MOE_RC; return true;
    }
    __device__ __forceinline__ const char* a_base(const Unit& u) const { return UP ? (const char*)A : (const char*)A + (size_t)u.pm * 256 * 1024 * 2; }
    __device__ __forceinline__ const char* b_base(const Unit& u, int seg) const {
        int elo, ehi; pair_of(u.x0 % 6, elo, ehi); const int g = u.x0 / 6;
        if (UP) { const int e = 4 * g + (u.pn < 4 ? elo : ehi); return (const char*)W + ((size_t)e * 1024 + (size_t)(u.pn & 3) * 256) * 1024 * 2; }
        const int e = 4 * g + (seg ? ehi : elo); return (const char*)W + ((size_t)e * 1024 + (size_t)u.pn * 256) * 512 * 2;
    }
    __device__ __forceinline__ void a_off(const Unit& u, const int (&R)[2], const int (&C)[2], unsigned (&vo)[2][2]) const {
        const i32x4* tw = tokw + (size_t)u.x0 * 32768 + MOE_RC * u.x1;
#pragma unroll
        for (int h = 0; h < 2; ++h)
#pragma unroll
            for (int i = 0; i < 2; ++i) { int r = h * 128 + R[i]; r = r < u.x2 ? r : 0; const int tok = ((const int*)(tw + r))[0]; vo[h][i] = (unsigned)(tok * 1024 + C[i]) * 2u; }
    }
};

typedef f32x4 AccT[2][2][4][2];
__device__ __forceinline__ u32x4 pack8(f32x4 v0, f32x4 v1) { u32x4 w; w.x = cvtpk(v0[0], v0[1]); w.y = cvtpk(v0[2], v0[3]); w.z = cvtpk(v1[0], v1[1]); w.w = cvtpk(v1[2], v1[3]); return w; }
__device__ __forceinline__ void unpack8(u32x4 w, f32x4& v0, f32x4& v1) { v0 = (f32x4){bf_lo(w.x), bf_hi(w.x), bf_lo(w.y), bf_hi(w.y)}; v1 = (f32x4){bf_lo(w.z), bf_hi(w.z), bf_lo(w.w), bf_hi(w.w)}; }

struct EpiProj {
    static constexpr bool PERM = true;
    bf16_t *Q, *K, *V, *U, *VG, *GA, *GGt; float* lnp; const float* bgate;
    __device__ __forceinline__ void operator()(const AccT& acc, const Unit& u, int wr, int wc, int fr, int fq) const {
        const int pn = u.pn; bf16_t* base; int ldc, colt, mode; const float* bias = nullptr;
        if (pn < 4) { base = Q; ldc = 1024; colt = pn * 256; mode = 0; }
        else if (pn == 4) { base = K; ldc = 256; colt = 0; mode = 0; }
        else if (pn == 5) { base = V; ldc = 256; colt = 0; mode = 0; }
        else if (pn < 10) { base = U; ldc = 1024; colt = (pn - 6) * 256; mode = 1; }
        else if (pn < 14) { base = VG; ldc = 1024; colt = (pn - 10) * 256; mode = 2; }
        else if (pn < 18) { base = GA; ldc = 1024; colt = (pn - 14) * 256; mode = 3; bias = bgate + colt; }
        else { base = GGt; ldc = 1024; colt = (pn - 18) * 256; mode = 3; bias = bgate + 1024 + colt; }
        const int row0 = u.pm * 256 + wr * 64 + fr, cw = wc * 32 + 8 * fq;
        f32x4 bv[2][2];
#pragma unroll
        for (int bj = 0; bj < 2; ++bj)
#pragma unroll
            for (int n = 0; n < 2; ++n) bv[bj][n] = (mode == 3) ? *(const f32x4*)(bias + cw + bj * 128 + 4 * n) : (f32x4){0.f, 0.f, 0.f, 0.f};
#pragma unroll
        for (int ai = 0; ai < 2; ++ai)
#pragma unroll
            for (int m = 0; m < 4; ++m) {
                const int row = row0 + ai * 128 + m * 16; bf16_t* rowp = base + (size_t)row * ldc + colt + cw; float s1 = 0.f, s2 = 0.f;
#pragma unroll
                for (int bj = 0; bj < 2; ++bj) {
                    f32x4 v0 = acc[ai][bj][m][0], v1 = acc[ai][bj][m][1];
                    if (mode == 1 || mode == 2) { v0 = gelu4(v0); v1 = gelu4(v1); }
                    if (mode == 2) { s1 += (v0[0] + v0[1]) + (v0[2] + v0[3]) + (v1[0] + v1[1]) + (v1[2] + v1[3]);
                        s2 += (v0[0] * v0[0] + v0[1] * v0[1]) + (v0[2] * v0[2] + v0[3] * v0[3]) + (v1[0] * v1[0] + v1[1] * v1[1]) + (v1[2] * v1[2] + v1[3] * v1[3]); }
                    if (mode == 3) { v0 += bv[bj][0]; v1 += bv[bj][1];
#pragma unroll
                        for (int e = 0; e < 4; ++e) { v0[e] = sigmoidf_(v0[e]); v1[e] = sigmoidf_(v1[e]); } }
                    *(u32x4*)(rowp + bj * 128) = pack8(v0, v1);
                }
                if (mode == 2) { s1 += __shfl_xor(s1, 16); s1 += __shfl_xor(s1, 32); s2 += __shfl_xor(s2, 16); s2 += __shfl_xor(s2, 32);
                    if (fq == 0) *(f32x2*)(lnp + ((size_t)row * 16 + (pn - 10) * 4 + wc) * 2) = (f32x2){s1, s2}; }
            }
    }
};
struct EpiMerge {
    static constexpr bool PERM = true;
    const bf16_t* GA; const bf16_t* GGt; bf16_t* M;
    __device__ __forceinline__ void operator()(const AccT& acc, const Unit& u, int wr, int wc, int fr, int fq) const {
        const int br = u.x0; const int row0 = u.pm * 256 + wr * 64 + fr, col0 = u.pn * 256 + wc * 32 + 8 * fq; const bf16_t* G = br ? GGt : GA;
        if (br) asm volatile("s_waitcnt vmcnt(0)" ::: "memory");
#pragma unroll
        for (int ai = 0; ai < 2; ++ai)
#pragma unroll
            for (int m = 0; m < 4; ++m) { const size_t off = (size_t)(row0 + ai * 128 + m * 16) * 1024 + col0;
#pragma unroll
                for (int bj = 0; bj < 2; ++bj) {
                    const u32x4 gw = *(const u32x4*)(G + off + bj * 128); f32x4 g0, g1; unpack8(gw, g0, g1);
                    f32x4 v0 = acc[ai][bj][m][0] * g0, v1 = acc[ai][bj][m][1] * g1;
                    if (br) { const u32x4 tw = __builtin_nontemporal_load((const u32x4*)(M + off + bj * 128)); f32x4 t0, t1; unpack8(tw, t0, t1); v0 += t0; v1 += t1; }
                    *(u32x4*)(M + off + bj * 128) = pack8(v0, v1);
                } }
    }
};
struct EpiOut {
    static constexpr bool PERM = false;
    const float* x; float* out; const float* mod; float* ssp;
    __device__ __forceinline__ void operator()(const AccT& acc, const Unit& u, int wr, int wc, int fr, int fq) const {
        const int row0 = u.pm * 256 + wr * 64 + fr, col0 = u.pn * 256 + wc * 32 + 4 * fq; const int b = (u.pm * 256) >> 12;
        const float* g1 = mod + (size_t)b * 6144 + 2048 + col0;
        f32x4 gv[2][2];
#pragma unroll
        for (int bj = 0; bj < 2; ++bj)
#pragma unroll
            for (int n = 0; n < 2; ++n) gv[bj][n] = *(const f32x4*)(g1 + bj * 128 + n * 16);
#pragma unroll
        for (int ai = 0; ai < 2; ++ai)
#pragma unroll
            for (int m = 0; m < 4; ++m) { const int row = row0 + ai * 128 + m * 16; const size_t off = (size_t)row * 1024 + col0; float ss = 0.f;
#pragma unroll
                for (int bj = 0; bj < 2; ++bj)
#pragma unroll
                    for (int n = 0; n < 2; ++n) { const f32x4 xv = *(const f32x4*)(x + off + bj * 128 + n * 16); const f32x4 o = xv + gv[bj][n] * acc[ai][bj][m][n];
                        *(f32x4*)(out + off + bj * 128 + n * 16) = o; ss += (o[0] * o[0] + o[1] * o[1]) + (o[2] * o[2] + o[3] * o[3]); }
                ss += __shfl_xor(ss, 16); ss += __shfl_xor(ss, 32);
                if (fq == 0) ssp[(size_t)row * 16 + u.pn * 4 + wc] = ss; }
    }
};
struct EpiMoeUp {
    static constexpr bool PERM = true;
    bf16_t* HID; const i32x4* tokw;
    __device__ __forceinline__ void operator()(const AccT& acc, const Unit& u, int wr, int wc, int fr_, int fq) const { int fr = fr_;
        const i32x4* tw = tokw + (size_t)u.x0 * 32768 + MOE_RC * u.x1; const int widx = u.pn < 4 ? 1 : 2;
        asm volatile("" : "+v"(fr));
#pragma unroll
        for (int ai = 0; ai < 2; ++ai)
#pragma unroll
            for (int m = 0; m < 4; ++m) { const int rl = ai * 128 + wr * 64 + m * 16 + fr;
                if (rl < u.x2) { const float w = __int_as_float(((const int*)(tw + rl))[widx]);
                    f32x4 h0, h1;
#pragma unroll
                    for (int e = 0; e < 4; ++e) { const float g0 = acc[ai][0][m][0][e], g1 = acc[ai][0][m][1][e];
                        h0[e] = g0 * sigmoidf_(g0) * acc[ai][1][m][0][e] * w; h1[e] = g1 * sigmoidf_(g1) * acc[ai][1][m][1][e] * w; }
                    *(u32x4*)(HID + ((size_t)u.pm * 256 + rl) * 1024 + u.pn * 128 + wc * 32 + 8 * fq) = pack8(h0, h1); } }
    }
};
struct EpiMoeDown {
    static constexpr bool PERM = false;
    float* out; const float* mod; const i32x4* tokw;
    __device__ __forceinline__ void operator()(const AccT& acc, const Unit& u, int wr, int wc, int fr, int fq) const {
        const i32x4* tw = tokw + (size_t)u.x0 * 32768 + MOE_RC * u.x1; const int col0 = u.pn * 256 + wc * 32 + 4 * fq;
#pragma unroll
        for (int ai = 0; ai < 2; ++ai)
#pragma unroll
            for (int m = 0; m < 4; ++m) { const int rl = ai * 128 + wr * 64 + m * 16 + fr;
                if (rl < u.x2) { const int tok = ((const int*)(tw + rl))[0]; const float* g2 = mod + (size_t)(tok >> 12) * 6144 + 5120 + col0; float* o = out + (size_t)tok * 1024 + col0;
#pragma unroll
                    for (int bj = 0; bj < 2; ++bj)
#pragma unroll
                        for (int n = 0; n < 2; ++n) { const f32x4 gv = *(const f32x4*)(g2 + bj * 128 + n * 16); const f32x4 xv = *(const f32x4*)(o + bj * 128 + n * 16);
                            *(f32x4*)(o + bj * 128 + n * 16) = xv + gv * acc[ai][bj][m][n]; } } }
    }
};

__device__ __forceinline__ void p0_transpose_item(const float* W, int srcld, int K, bf16_t* WT, int k0, int n0, int drow0, LAS float* scr, int lane) {
#pragma unroll 8
    for (int i = 0; i < 32; ++i) { const int kk = 2 * i + (lane >> 5); scr[kk * 33 + (lane & 31)] = W[(size_t)(k0 + kk) * srcld + n0 + (lane & 31)]; }
    LDS_WAIT(); asm volatile("" ::: "memory");
    const int c = lane & 7;
#pragma unroll
    for (int j = 0; j < 4; ++j) { const int n = (lane >> 3) + 8 * j; const LAS float* s = scr + (8 * c) * 33 + n;
        u32x4 o; o.x = cvtpk(s[0 * 33], s[1 * 33]); o.y = cvtpk(s[2 * 33], s[3 * 33]); o.z = cvtpk(s[4 * 33], s[5 * 33]); o.w = cvtpk(s[6 * 33], s[7 * 33]);
        *(u32x4*)(WT + (size_t)(drow0 + n) * K + k0 + 8 * c) = o; }
    LDS_WAIT(); asm volatile("" ::: "memory");
}

struct Args { const float* in[25]; float* out; unsigned char* ws; int ph_lo, ph_hi, li, pad; };

__device__ __forceinline__ int crow(int r, int hi) { return (r & 3) + 8 * (r >> 2) + 4 * hi; }
__device__ __forceinline__ s16x4 tr16(const LAS unsigned char* p) { return __builtin_bit_cast(s16x4, __builtin_amdgcn_ds_read_tr16_b64_v4i16((LAS s16x4*)p)); }
__device__ __forceinline__ void attn_unit(LAS unsigned char* lds, int b, int n, int kh, bf16_t* QY, const bf16_t* Kb, const bf16_t* Vb, const float* qg, const float* kg, const float* sinks) {
    const int tid = threadIdx.x, lane = tid & 63, wid = __builtin_amdgcn_readfirstlane(tid >> 6), r32 = lane & 31, hi = lane >> 5;
    LAS unsigned char* Ks = lds; LAS unsigned char* Vs = lds + 32768;
    {
        const int key = tid >> 1, half = tid & 1; const bool ok = (n > 0) || (key >= 128);
        const size_t row = (size_t)b * SEQ + (size_t)(n - 1) * BLK + key;
        u32x4 kr[4], vr[4];
#pragma unroll
        for (int c = 0; c < 4; ++c) { if (ok) { kr[c] = *(const u32x4*)(Kb + row * 256 + kh * 64 + half * 32 + c * 8); vr[c] = *(const u32x4*)(Vb + row * 256 + kh * 64 + half * 32 + c * 8); } else { kr[c] = (u32x4){0u, 0u, 0u, 0u}; vr[c] = kr[c]; } }
        float ss = 0.f; f32x4 kf[4][2];
#pragma unroll
        for (int c = 0; c < 4; ++c) { unpack8(kr[c], kf[c][0], kf[c][1]);
#pragma unroll
            for (int e = 0; e < 4; ++e) ss += kf[c][0][e] * kf[c][0][e] + kf[c][1][e] * kf[c][1][e]; }
        ss += __shfl_xor(ss, 1);
        const float rs = rsqrtf(ss * (1.0f / 64.0f) + EPS);
#pragma unroll
        for (int c = 0; c < 4; ++c) { const f32x4 g0 = *(const f32x4*)(kg + half * 32 + c * 8), g1 = *(const f32x4*)(kg + half * 32 + c * 8 + 4);
            const u32x4 w = pack8(kf[c][0] * rs * g0, kf[c][1] * rs * g1); const int ch = half * 4 + c;
            *(LAS u32x4*)(Ks + key * 128 + ((ch ^ (key & 7)) << 4)) = w;
            *(LAS u32x4*)(Vs + key * 128 + (ch << 4)) = vr[c]; }
    }
    __syncthreads();
    const int hh = wid >> 1, head = kh * 4 + hh;
    const float slope2 = fast_exp2(-0.5f * (float)(head + 1)) * LOG2E, sink2 = sinks[head] * LOG2E;
#pragma unroll 1
    for (int ab = 0; ab < 2; ++ab) {
        const int a = 2 * (wid & 1) + ab, qi = 32 * a + r32;
        bf16_t* qp = QY + ((size_t)b * SEQ + (size_t)n * BLK + qi) * 1024 + head * 64;
        f32x4 qf[4][2]; float ss = 0.f;
#pragma unroll
        for (int s = 0; s < 4; ++s) { const u32x4 w = *(const u32x4*)(qp + 16 * s + 8 * hi); unpack8(w, qf[s][0], qf[s][1]);
#pragma unroll
            for (int e = 0; e < 4; ++e) ss += qf[s][0][e] * qf[s][0][e] + qf[s][1][e] * qf[s][1][e]; }
        ss += __shfl_xor(ss, 32);
        const float rs = rsqrtf(ss * (1.0f / 64.0f) + EPS) * (0.125f * LOG2E);
        bf16x8 qr[4];
#pragma unroll
        for (int s = 0; s < 4; ++s) { const f32x4 g0 = *(const f32x4*)(qg + 16 * s + 8 * hi), g1 = *(const f32x4*)(qg + 16 * s + 8 * hi + 4);
            qr[s] = __builtin_bit_cast(bf16x8, pack8(qf[s][0] * rs * g0, qf[s][1] * rs * g1)); }
        f32x16 p[5]; const float hoff = slope2 * (float)(4 * hi);
#pragma unroll
        for (int tt = 0; tt < 5; ++tt) { const int key = 32 * (a + tt) + r32; f32x16 c;
#pragma unroll
            for (int r = 0; r < 16; ++r) c[r] = hoff;
#pragma unroll
            for (int s = 0; s < 4; ++s) { const int ch = 2 * s + hi; const bf16x8 kfr = *(const LAS bf16x8*)(Ks + key * 128 + ((ch ^ (key & 7)) << 4));
                c = __builtin_amdgcn_mfma_f32_32x32x16_bf16(kfr, qr[s], c, 0, 0, 0); }
            p[tt] = c; __builtin_amdgcn_sched_barrier(0); }
        int dbase = 128 + r32 - 4 * hi; asm volatile("" : "+v"(dbase));
        const unsigned lim = (n > 0) ? 128u : (unsigned)(qi + 1);
        const float sinkq = sink2 + slope2 * (float)(128 + r32);
        float mx = sinkq;
#pragma unroll
        for (int tt = 0; tt < 5; ++tt) {
#pragma unroll
            for (int r = 0; r < 16; ++r) { const int cst = 32 * tt + (r & 3) + 8 * (r >> 2); const int dist = dbase - cst; const bool valid = (unsigned)dist < lim;
                const float v = valid ? fmaf(slope2, (float)cst, p[tt][r]) : -1e30f; p[tt][r] = v; mx = fmaxf(mx, v); }
            __builtin_amdgcn_sched_barrier(0); }
        mx = fmaxf(mx, __shfl_xor(mx, 32));
        float l = 0.f;
#pragma unroll
        for (int tt = 0; tt < 5; ++tt) {
#pragma unroll
            for (int r = 0; r < 16; ++r) { const float e = fast_exp2(p[tt][r] - mx); p[tt][r] = e; l += e; }
            __builtin_amdgcn_sched_barrier(0); }
        l += __shfl_xor(l, 32); l += fast_exp2(sinkq - mx);
        f32x16 o0 = {}, o1 = {};
        const LAS unsigned char* vbase = Vs + (32 * a + 4 * hi + ((lane & 15) >> 2)) * 128 + (16 * ((lane >> 4) & 1)) * 2 + 8 * (lane & 3);
#pragma unroll
        for (int tt = 0; tt < 5; ++tt)
#pragma unroll
            for (int s2 = 0; s2 < 2; ++s2) {
                u32x4 pw; pw.x = cvtpk(p[tt][8 * s2 + 0], p[tt][8 * s2 + 1]); pw.y = cvtpk(p[tt][8 * s2 + 2], p[tt][8 * s2 + 3]); pw.z = cvtpk(p[tt][8 * s2 + 4], p[tt][8 * s2 + 5]); pw.w = cvtpk(p[tt][8 * s2 + 6], p[tt][8 * s2 + 7]);
                const bf16x8 pb = __builtin_bit_cast(bf16x8, pw);
                const LAS unsigned char* vp = vbase + (32 * tt + 16 * s2) * 128;
                { const s16x4 lo = tr16(vp), hi4 = tr16(vp + 8 * 128); const bf16x8 vf = __builtin_shufflevector(lo, hi4, 0, 1, 2, 3, 4, 5, 6, 7); o0 = __builtin_amdgcn_mfma_f32_32x32x16_bf16(vf, pb, o0, 0, 0, 0); }
                { const s16x4 lo = tr16(vp + 64), hi4 = tr16(vp + 64 + 8 * 128); const bf16x8 vf = __builtin_shufflevector(lo, hi4, 0, 1, 2, 3, 4, 5, 6, 7); o1 = __builtin_amdgcn_mfma_f32_32x32x16_bf16(vf, pb, o1, 0, 0, 0); }
                __builtin_amdgcn_sched_barrier(0);
            }
        const float inv = 1.0f / l;
#pragma unroll
        for (int g4 = 0; g4 < 4; ++g4) {
            u32x2 w0, w1; w0.x = cvtpk(o0[4 * g4] * inv, o0[4 * g4 + 1] * inv); w0.y = cvtpk(o0[4 * g4 + 2] * inv, o0[4 * g4 + 3] * inv);
            w1.x = cvtpk(o1[4 * g4] * inv, o1[4 * g4 + 1] * inv); w1.y = cvtpk(o1[4 * g4 + 2] * inv, o1[4 * g4 + 3] * inv);
            *(u32x2*)(qp + 8 * g4 + 4 * hi) = w0; *(u32x2*)(qp + 32 + 8 * g4 + 4 * hi) = w1; }
    }
    __syncthreads();
}

constexpr int VN_STRIDE = 288;
__device__ __forceinline__ void gmlp_unit(LAS unsigned char* lds, int b, int n, int g, const bf16_t* VG, bf16_t* UY, const float* lnp, const float* gain, const float* bias, const bf16_t* wtril, const float* bsp) {
    const int tid = threadIdx.x, lane = tid & 63, wid = __builtin_amdgcn_readfirstlane(tid >> 6), fr = lane & 15, fq = lane >> 4;
    LAS unsigned char* vn = lds; LAS f32x2* st = (LAS f32x2*)(lds + 40960);
    const size_t row0 = (size_t)b * SEQ + (size_t)n * BLK;
    if (tid < 128) { const f32x2* pp = (const f32x2*)(lnp + (row0 + tid) * 32); float s1 = 0.f, s2 = 0.f;
#pragma unroll
        for (int k = 0; k < 16; ++k) { const f32x2 v = pp[k]; s1 += v.x; s2 += v.y; }
        const float mean = s1 * (1.0f / 1024.0f); const float var = fmaxf(s2 * (1.0f / 1024.0f) - mean * mean, 0.f);
        st[tid] = (f32x2){mean, rsqrtf(var + EPS)}; }
    __syncthreads();
#pragma unroll
    for (int it = 0; it < 4; ++it) { const int idx = tid + 512 * it, s = idx >> 4, c8 = idx & 15; const int ch = g * 128 + c8 * 8;
        const u32x4 w = *(const u32x4*)(VG + (row0 + s) * 1024 + ch); f32x4 v0, v1; unpack8(w, v0, v1); const f32x2 ms = st[s];
        const f32x4 g0 = *(const f32x4*)(gain + ch), g1 = *(const f32x4*)(gain + ch + 4), b0 = *(const f32x4*)(bias + ch), b1 = *(const f32x4*)(bias + ch + 4);
        v0 = (v0 - ms.x) * ms.y * g0 + b0; v1 = (v1 - ms.x) * ms.y * g1 + b1;
        *(LAS u32x4*)(vn + s * VN_STRIDE + c8 * 16) = pack8(v0, v1); }
    __syncthreads();
    const int trow = 16 * wid + fr;
    bf16x8 wf[4];
#pragma unroll
    for (int ks = 0; ks < 4; ++ks) wf[ks] = *(const bf16x8*)(wtril + ((size_t)g * 128 + trow) * 128 + 32 * ks + 8 * fq);
    const float bs = bsp[g * 128 + trow];
#pragma unroll
    for (int ct = 0; ct < 8; ++ct) { f32x4 acc = {0.f, 0.f, 0.f, 0.f};
#pragma unroll
        for (int ks = 0; ks < 4; ++ks) { const LAS unsigned char* bp = vn + (32 * ks + 8 * fq + ((lane & 15) >> 2)) * VN_STRIDE + (16 * ct + 4 * (lane & 3)) * 2;
            const s16x4 lo = tr16(bp), hi4 = tr16(bp + 4 * VN_STRIDE); const bf16x8 bfr = __builtin_shufflevector(lo, hi4, 0, 1, 2, 3, 4, 5, 6, 7);
            acc = __builtin_amdgcn_mfma_f32_16x16x32_bf16(bfr, wf[ks], acc, 0, 0, 0); }
        bf16_t* up = UY + (row0 + trow) * 1024 + g * 128 + 16 * ct + 4 * fq; const u32x2 uw = *(const u32x2*)up;
        u32x2 o; o.x = cvtpk(bf_lo(uw.x) * (acc[0] + bs), bf_hi(uw.x) * (acc[1] + bs)); o.y = cvtpk(bf_lo(uw.y) * (acc[2] + bs), bf_hi(uw.y) * (acc[3] + bs));
        *(u32x2*)up = o; }
    __syncthreads();
}


__device__ __forceinline__ void attn_unit_naive(LAS unsigned char* lds, int b, int n, int kh, bf16_t* QY, const bf16_t* Kb, const bf16_t* Vb, const float* qg, const float* kg, const float* sinks) {
    const int tid = threadIdx.x;
    LAS float* Kf = (LAS float*)lds;
    LAS float* Vf = (LAS float*)(lds + 66560);
    for (int idx = tid; idx < 256 * 64; idx += NTHREADS) { const int key = idx >> 6, d = idx & 63; const bool ok = (n > 0) || (key >= 128);
        const long row = (long)b * SEQ + (long)(n - 1) * BLK + key;
        Kf[key * 65 + d] = ok ? bf_lo((unsigned)Kb[row * 256 + kh * 64 + d]) : 0.f; Vf[key * 64 + d] = ok ? bf_lo((unsigned)Vb[row * 256 + kh * 64 + d]) : 0.f; }
    __syncthreads();
    if (tid < 256) { float ss = 0.f; for (int d = 0; d < 64; ++d) ss += Kf[tid * 65 + d] * Kf[tid * 65 + d]; const float rs = rsqrtf(ss * (1.0f / 64.0f) + EPS);
        for (int d = 0; d < 64; ++d) Kf[tid * 65 + d] = Kf[tid * 65 + d] * rs * kg[d]; }
    __syncthreads();
    const int qi = tid >> 2, hh = tid & 3, head = kh * 4 + hh;
    bf16_t* qp = QY + ((size_t)b * SEQ + (size_t)n * BLK + qi) * 1024 + head * 64;
    float q[64]; float ss = 0.f;
#pragma unroll
    for (int d = 0; d < 64; ++d) { q[d] = bf_lo((unsigned)qp[d]); ss += q[d] * q[d]; }
    const float rs = rsqrtf(ss * (1.0f / 64.0f) + EPS) * 0.125f;
#pragma unroll
    for (int d = 0; d < 64; ++d) q[d] = q[d] * rs * qg[d];
    const float slope = exp2f(-0.5f * (float)(head + 1)), sink = sinks[head];
    float m = sink, l = 1.0f; float o[64];
#pragma unroll
    for (int d = 0; d < 64; ++d) o[d] = 0.f;
    for (int dist = 0; dist < 128; ++dist) { const int j = 128 + qi - dist; if (n == 0 && j < 128) break;
        float s = 0.f;
#pragma unroll
        for (int d = 0; d < 64; ++d) s += q[d] * Kf[j * 65 + d];
        s -= slope * (float)dist;
        const float mn = fmaxf(m, s), f = __expf(m - mn), e = __expf(s - mn); l = l * f + e; m = mn;
#pragma unroll
        for (int d = 0; d < 64; ++d) o[d] = o[d] * f + e * Vf[j * 64 + d]; }
    const float inv = 1.0f / l;
#pragma unroll
    for (int d = 0; d < 64; d += 2) *(unsigned*)(qp + d) = cvtpk(o[d] * inv, o[d + 1] * inv);
    __syncthreads();
}
__device__ __forceinline__ void gmlp_unit_naive(LAS unsigned char* lds, int b, int n, int g, const bf16_t* VG, bf16_t* UY, const float* lnp, const float* gain, const float* bias, const float* wsp, const float* bsp) {
    const int tid = threadIdx.x;
    LAS float* vnf = (LAS float*)lds;
    LAS f32x2* st = (LAS f32x2*)(lds + 65536);
    const size_t row0 = (size_t)b * SEQ + (size_t)n * BLK;
    if (tid < 128) { const f32x2* pp = (const f32x2*)(lnp + (row0 + tid) * 32); float s1 = 0.f, s2 = 0.f;
        for (int k = 0; k < 16; ++k) { const f32x2 v = pp[k]; s1 += v.x; s2 += v.y; }
        const float mean = s1 * (1.0f / 1024.0f); const float var = fmaxf(s2 * (1.0f / 1024.0f) - mean * mean, 0.f); st[tid] = (f32x2){mean, rsqrtf(var + EPS)}; }
    __syncthreads();
    for (int idx = tid; idx < 128 * 128; idx += NTHREADS) { const int s = idx >> 7, c = idx & 127; const f32x2 ms = st[s];
        const float v = bf_lo((unsigned)VG[(row0 + s) * 1024 + g * 128 + c]); const float y = (v - ms.x) * ms.y * gain[g * 128 + c] + bias[g * 128 + c];
        vnf[s * 128 + c] = bf_lo(cvtpk(y, 0.f) & 0xffffu); }
    __syncthreads();
    for (int idx = tid; idx < 128 * 128; idx += NTHREADS) { const int t = idx >> 7, c = idx & 127; float acc = 0.f;
        for (int s = 0; s <= t; ++s) acc += wsp[((size_t)g * 128 + t) * 128 + s] * vnf[s * 128 + c];
        bf16_t* up = UY + (row0 + t) * 1024 + g * 128 + c; const float u = bf_lo((unsigned)*up);
        *up = (bf16_t)(cvtpk(u * (acc + bsp[g * 128 + t]), 0.f) & 0xffffu); }
    __syncthreads();
}

__global__ void __launch_bounds__(NTHREADS, 2) mk_fwd(Args args) {
    extern __shared__ __attribute__((aligned(16))) unsigned char lds_raw[];
    LAS unsigned char* lds = (LAS unsigned char*)lds_raw;
    volatile LAS unsigned* MISC = (volatile LAS unsigned*)(lds + MISC_OFF);
    const int tid = threadIdx.x, lane = tid & 63, wave = __builtin_amdgcn_readfirstlane(tid >> 6);
    const int G = gridDim.x; const int bx = blockIdx.x; const int vcu = (G % 8 == 0) ? (bx % 8) * (G / 8) + bx / 8 : bx;
    unsigned char* ws = args.ws;
    unsigned* ctl = (unsigned*)(ws + WS_CTL);
    float* modp = (float*)(ws + WS_MOD);
    bf16_t* WTRIL = (bf16_t*)(ws + WS_WTRIL); bf16_t* WIN = (bf16_t*)(ws + WS_WIN); bf16_t* WOA = (bf16_t*)(ws + WS_WOA); bf16_t* WOG = (bf16_t*)(ws + WS_WOG); bf16_t* WOUT = (bf16_t*)(ws + WS_WOUT);
    bf16_t* WGU = (bf16_t*)(ws + WS_WGU); bf16_t* WDN = (bf16_t*)(ws + WS_WDN);
    float* LNP = (float*)(ws + WS_LNP); float* SSP = (float*)(ws + WS_SSP); i32x4* TOKW = (i32x4*)(ws + WS_TOK);
    bf16_t* HB = (bf16_t*)(ws + WS_H); bf16_t* QB = (bf16_t*)(ws + WS_Q); bf16_t* KB = (bf16_t*)(ws + WS_K); bf16_t* VB = (bf16_t*)(ws + WS_V);
    bf16_t* UB = (bf16_t*)(ws + WS_U); bf16_t* VGB = (bf16_t*)(ws + WS_VG); bf16_t* GAB = (bf16_t*)(ws + WS_GA); bf16_t* GGB = (bf16_t*)(ws + WS_GG); bf16_t* HID = (bf16_t*)(ws + WS_HID);
    const float* x = args.in[0]; float* out = args.out;

    for (int u = tid; u < (LDS_BYTES - LDSCTL_OFF) / 4; u += NTHREADS) ((LAS unsigned*)(lds + LDSCTL_OFF))[u] = 0u;
    __syncthreads();
    XcdBarrier bar; bar.bar = ctl + CW_BAR; bar.x = 0; bar.st = nullptr;
    if (N_LAUNCHES == 1) bar = xcd_barrier_post(ctl + CW_BAR, MISC + 8);
#define GRID_BAR() do { if (N_LAUNCHES == 1) xcd_barrier(bar); } while (0)
    const int lo = args.ph_lo, hi = args.ph_hi;
#ifdef MK_ONLY
#define IN(k) ((k) == MK_ONLY)
#else
#define IN(k) (lo <= (k) && (k) < hi)
#endif
#define BOTH(k) (IN(k) && IN((k) + 1))
    const int gw = vcu * NWAVES + wave, NGW = G * NWAVES;

    if (IN(0)) {
        const float* c = args.in[1]; const float* w_ada = args.in[2]; const float* b_ada = args.in[3];
        if (vcu < 192) {
            LAS float* sc = (LAS float*)lds;
            LAS float* part = (LAS float*)(lds + 32768);
            for (int i = tid; i < 8192; i += NTHREADS) { const float v = c[i]; sc[i] = v / (1.0f + __expf(-v)); }
            __syncthreads();
            const int col = 32 * vcu + (lane & 31), kh2 = lane >> 5, kbeg = 128 * wave + 64 * kh2;
            float a8[8] = {0.f, 0.f, 0.f, 0.f, 0.f, 0.f, 0.f, 0.f};
#pragma unroll 8
            for (int kk = 0; kk < 64; ++kk) { const int k = kbeg + kk; const float wv = w_ada[(size_t)k * 6144 + col];
#pragma unroll
                for (int bb = 0; bb < 8; ++bb) a8[bb] += sc[bb * 1024 + k] * wv; }
#pragma unroll
            for (int bb = 0; bb < 8; ++bb) part[((wave * 2 + kh2) * 8 + bb) * 32 + (lane & 31)] = a8[bb];
            __syncthreads();
            if (tid < 256) { const int bb = tid >> 5, cl = tid & 31; float s = 0.f;
#pragma unroll
                for (int p = 0; p < 16; ++p) s += part[(p * 8 + bb) * 32 + cl];
                modp[(size_t)bb * 6144 + 32 * vcu + cl] = s + b_ada[32 * vcu + cl]; }
            __syncthreads();
        }
        {
            LAS float* scr = (LAS float*)(lds + wave * 16384);
            constexpr int I_IN = 16 * 176, I_SQ = 16 * 32, I_GU = 16 * 16, I_DN = 8 * 32;
            constexpr int NITEMS = I_IN + 3 * I_SQ + 32 * I_GU + 16 * I_DN;
            for (int it = gw; it < NITEMS; it += NGW) {
                int r = it;
                if (r < I_IN) { const int kb = r / 176, nb = r % 176; p0_transpose_item(args.in[5], INW, 1024, WIN, 64 * kb, 32 * nb, 32 * nb, scr, lane); continue; } r -= I_IN;
                if (r < 3 * I_SQ) { const int w = r / I_SQ; r %= I_SQ; const int kb = r / 32, nb = r % 32; p0_transpose_item(args.in[14 + w], 1024, 1024, w == 0 ? WOA : (w == 1 ? WOG : WOUT), 64 * kb, 32 * nb, 32 * nb, scr, lane); continue; } r -= 3 * I_SQ;
                if (r < 32 * I_GU) { const int e = r / (2 * I_GU); r %= 2 * I_GU; const int up = r / I_GU; r %= I_GU; const int kb = r / 16, nb = r % 16; const int f0 = 32 * nb;
                    p0_transpose_item(args.in[22 + up] + (size_t)e * 1024 * 512, 512, 1024, WGU + (size_t)e * 1024 * 1024, 64 * kb, f0, 256 * (f0 / 128) + (f0 % 128) + 128 * up, scr, lane); continue; } r -= 32 * I_GU;
                { const int e = r / I_DN; r %= I_DN; const int kb = r / 32, nb = r % 32; p0_transpose_item(args.in[24] + (size_t)e * 512 * 1024, 1024, 512, WDN + (size_t)e * 1024 * 512, 64 * kb, 32 * nb, 32 * nb, scr, lane); }
            }
        }
        {
            const float* wsp = args.in[12];
            for (int i = vcu * NTHREADS + tid; i < NGG * 128 * 128; i += G * NTHREADS) { const int t = (i >> 7) & 127, s = i & 127; const float v = (s <= t) ? wsp[i] : 0.f; WTRIL[i] = (bf16_t)(cvtpk(v, 0.f) & 0xffffu); }
        }
        if (BOTH(0)) GRID_BAR();
    }

    if (IN(1)) {
        const float* g1 = args.in[4];
        for (int r = gw; r < T; r += NGW) { const int b = r >> 12; const f32x4* xr = (const f32x4*)(x + (size_t)r * D) + lane; f32x4 v[4]; float ss = 0.f;
#pragma unroll
            for (int j = 0; j < 4; ++j) { v[j] = xr[64 * j]; ss += (v[j][0] * v[j][0] + v[j][1] * v[j][1]) + (v[j][2] * v[j][2] + v[j][3] * v[j][3]); }
            const float rstd = rsqrtf(wave_sum(ss) * (1.0f / D) + EPS);
            const float* mb = modp + (size_t)b * 6144; u32x2* o8 = (u32x2*)(HB + (size_t)r * D) + lane;
#pragma unroll
            for (int j = 0; j < 4; ++j) { const int cidx = 4 * lane + 256 * j; const f32x4 gg = *(const f32x4*)(g1 + cidx), sh = *(const f32x4*)(mb + cidx), sc = *(const f32x4*)(mb + 1024 + cidx);
                const f32x4 h = (v[j] * rstd * gg) * (sc + 1.0f) + sh; u32x2 w; w.x = cvtpk(h[0], h[1]); w.y = cvtpk(h[2], h[3]); o8[64 * j] = w; } }
        if (BOTH(1)) GRID_BAR();
    }

    if (IN(2)) {
        DenseSched S{HB, WIN, T / 256, INW / 256, G, bx};
        EpiProj E{QB, KB, VB, UB, VGB, GAB, GGB, LNP, args.in[6]};
        pg8::gemm_phase<EpiProj, DenseSched, true>(lds + RING_OFF, S, E);
        if (BOTH(2)) GRID_BAR();
    }

    if (IN(3)) {
        for (int u = vcu; u < BATCH * NBLK * NKV; u += G) { const int kh = u & 3, n = (u >> 2) & 31, b = u >> 7;
#ifdef NAIVE_ATTN
            attn_unit_naive(lds, b, n, kh, QB, KB, VB, args.in[7], args.in[8], args.in[9]); }
#else
            attn_unit(lds, b, n, kh, QB, KB, VB, args.in[7], args.in[8], args.in[9]); }
#endif
        for (int u = vcu; u < BATCH * NBLK * NGG; u += G) { const int g = u & 7, n = (u >> 3) & 31, b = u >> 8;
#ifdef NAIVE_GMLP
            gmlp_unit_naive(lds, b, n, g, VGB, UB, LNP, args.in[10], args.in[11], args.in[12], args.in[13]); }
#else
            gmlp_unit(lds, b, n, g, VGB, UB, LNP, args.in[10], args.in[11], WTRIL, args.in[13]); }
#endif
        if (BOTH(3)) GRID_BAR();
    }

    if (IN(4)) {
        MergeSched S{QB, UB, WOA, WOG, T / 256, D / 256, G, bx};
        EpiMerge E{GAB, GGB, VGB};
        pg8::gemm_phase<EpiMerge, MergeSched, true>(lds + RING_OFF, S, E);
        if (BOTH(4)) GRID_BAR();
    }

    if (IN(5)) {
        DenseSched S{VGB, WOUT, T / 256, D / 256, G, bx};
        EpiOut E{x, out, modp, SSP};
        pg8::gemm_phase<EpiOut, DenseSched, true>(lds + RING_OFF, S, E);
        if (BOTH(5)) GRID_BAR();
    }

    if (IN(6)) {
        LAS float* wrt = (LAS float*)lds;
        LAS int* rbk = (LAS int*)(lds + 81920); LAS float* rwl = (LAS float*)(lds + 81920 + 512); LAS float* rwh = (LAS float*)(lds + 81920 + 1024); LAS int* bbase = (LAS int*)(lds + 81920 + 1536);
        const float* wgr = args.in[18]; const float* bgr = args.in[19]; const float* wer = args.in[20]; const float* ber = args.in[21]; const float* g2 = args.in[17];
        for (int i = tid; i < 1024 * 4; i += NTHREADS) wrt[(i & 3) * 1024 + (i >> 2)] = wgr[i];
        for (int i = tid; i < 1024 * 16; i += NTHREADS) wrt[(4 + (i & 15)) * 1024 + (i >> 4)] = wer[i];
        __syncthreads();
        const int rpb = T / G;
        for (int rl = wave; rl < rpb; rl += NWAVES) { const int r = vcu * rpb + rl, b = r >> 12;
            const f32x4* xr = (const f32x4*)(out + (size_t)r * D) + lane; f32x4 v[4];
#pragma unroll
            for (int j = 0; j < 4; ++j) v[j] = xr[64 * j];
            float ss = 0.f;
#pragma unroll
            for (int k = 0; k < 16; ++k) ss += SSP[(size_t)r * 16 + k];
            const float rstd = rsqrtf(ss * (1.0f / D) + EPS);
            const float* mb = modp + (size_t)b * 6144; u32x2* o8 = (u32x2*)(HB + (size_t)r * D) + lane;
            float lg[20];
#pragma unroll
            for (int e = 0; e < 20; ++e) lg[e] = 0.f;
#pragma unroll
            for (int j = 0; j < 4; ++j) { const int cidx = 4 * lane + 256 * j; const f32x4 gg = *(const f32x4*)(g2 + cidx), sh = *(const f32x4*)(mb + 3072 + cidx), sc = *(const f32x4*)(mb + 4096 + cidx);
                const f32x4 h = (v[j] * rstd * gg) * (sc + 1.0f) + sh; u32x2 w; w.x = cvtpk(h[0], h[1]); w.y = cvtpk(h[2], h[3]); o8[64 * j] = w;
#pragma unroll
                for (int e = 0; e < 20; ++e) { const f32x4 wv = *(const LAS f32x4*)(wrt + e * 1024 + cidx); lg[e] += (h[0] * wv[0] + h[1] * wv[1]) + (h[2] * wv[2] + h[3] * wv[3]); } }
#pragma unroll
            for (int e = 0; e < 20; ++e) lg[e] = wave_sum(lg[e]);
            float gl0 = lg[0] + bgr[0], gl1 = lg[1] + bgr[1], gl2 = lg[2] + bgr[2], gl3 = lg[3] + bgr[3];
            int gi = 0; float gm = gl0; if (gl1 > gm) { gm = gl1; gi = 1; } if (gl2 > gm) { gm = gl2; gi = 2; } if (gl3 > gm) { gm = gl3; gi = 3; }
            const float gwt = 1.0f / (__expf(gl0 - gm) + __expf(gl1 - gm) + __expf(gl2 - gm) + __expf(gl3 - gm));
            float e0 = 0.f, e1 = 0.f, e2 = 0.f, e3 = 0.f;
#pragma unroll
            for (int q = 0; q < 4; ++q) if (gi == q) { e0 = lg[4 + 4 * q] + ber[4 * q]; e1 = lg[5 + 4 * q] + ber[4 * q + 1]; e2 = lg[6 + 4 * q] + ber[4 * q + 2]; e3 = lg[7 + 4 * q] + ber[4 * q + 3]; }
            int i1 = 0; float v1 = e0; if (e1 > v1) { v1 = e1; i1 = 1; } if (e2 > v1) { v1 = e2; i1 = 2; } if (e3 > v1) { v1 = e3; i1 = 3; }
            int i2 = -1; float v2 = -INFINITY;
            if (i1 != 0 && e0 > v2) { v2 = e0; i2 = 0; } if (i1 != 1 && e1 > v2) { v2 = e1; i2 = 1; } if (i1 != 2 && e2 > v2) { v2 = e2; i2 = 2; } if (i1 != 3 && e3 > v2) { v2 = e3; i2 = 3; }
            const float dd = __expf(v2 - v1), w1 = gwt / (1.0f + dd), w2 = gwt * dd / (1.0f + dd);
            const int elo = i1 < i2 ? i1 : i2, ehi = i1 < i2 ? i2 : i1; const float wlo = i1 < i2 ? w1 : w2, whi = i1 < i2 ? w2 : w1;
            const int pp = elo == 0 ? ehi - 1 : (elo == 1 ? ehi + 1 : 5);
            if (lane == 0) { rbk[rl] = gi * 6 + pp; rwl[rl] = wlo; rwh[rl] = whi; }
        }
        __syncthreads();
        if (tid < NBUCKET) { int cnt = 0; for (int i = 0; i < rpb; ++i) cnt += (rbk[i] == tid) ? 1 : 0;
            bbase[tid] = cnt ? (int)__hip_atomic_fetch_add(ctl + CW_CNT + 64 * tid, (unsigned)cnt, RLX_AGENT) : 0; }
        __syncthreads();
        if (tid < rpb) { const int bk = rbk[tid]; int rank = 0; for (int i = 0; i < tid; ++i) rank += (rbk[i] == bk) ? 1 : 0;
            TOKW[(size_t)bk * 32768 + bbase[bk] + rank] = (i32x4){vcu * rpb + tid, __float_as_int(rwl[tid]), __float_as_int(rwh[tid]), 0}; }
        __syncthreads();
        if (BOTH(6)) GRID_BAR();
    }

    LAS int* tcnt = (LAS int*)(lds + TAB_OFF); LAS int* ttp = tcnt + 32;
    if (IN(7) || IN(8)) {
        if (tid < NBUCKET) tcnt[tid] = (int)__hip_atomic_load(ctl + CW_CNT + 64 * tid, RLX_AGENT);
        __syncthreads();
        if (tid == 0) { int acc = 0; for (int k = 0; k < NBUCKET; ++k) { ttp[k] = acc; acc += (tcnt[k] + MOE_RC - 1) / MOE_RC; } ttp[NBUCKET] = acc; }
        __syncthreads();
    }

    if (IN(7)) {
        MoeSched<true> S{HB, WGU, TOKW, tcnt, ttp, G, vcu};
        EpiMoeUp E{HID, TOKW};
        pg8::gemm_phase<EpiMoeUp, MoeSched<true>, true>(lds + RING_OFF, S, E);
        if (BOTH(7)) GRID_BAR();
    }

    if (IN(8)) {
        MoeSched<false> S{HID, WDN, TOKW, tcnt, ttp, G, vcu};
        EpiMoeDown E{out, modp, TOKW};
        pg8::gemm_phase<EpiMoeDown, MoeSched<false>, true>(lds + RING_OFF, S, E);
    }
#undef IN
#undef BOTH
#undef GRID_BAR
}

extern "C" void kernel_launch(void* const* d_in, const int* in_sizes, int n_in, void* d_out, int out_size, void* d_ws, size_t ws_size, hipStream_t stream) {
    static int grid = 0;
    if (grid == 0) {
        if (n_in != 25 || in_sizes[0] != T * D || out_size != T * D || ws_size < WS_END) { fprintf(stderr, "kernel_launch: unexpected shapes (n_in %d, in0 %d, out %d, ws %zu); nothing launched\n", n_in, n_in > 0 ? in_sizes[0] : -1, out_size, ws_size); grid = -1; return; }
        int dev = 0, cus = 0, per_cu = 0;
        if (hipGetDevice(&dev) != hipSuccess || hipDeviceGetAttribute(&cus, hipDeviceAttributeMultiprocessorCount, dev) != hipSuccess) { fprintf(stderr, "kernel_launch: device query failed\n"); grid = -1; return; }
        if (hipFuncSetAttribute((const void*)mk_fwd, hipFuncAttributeMaxDynamicSharedMemorySize, LDS_BYTES) != hipSuccess) { fprintf(stderr, "kernel_launch: hipFuncSetAttribute failed\n"); grid = -1; return; }
        if (hipOccupancyMaxActiveBlocksPerMultiprocessor(&per_cu, (const void*)mk_fwd, NTHREADS, LDS_BYTES) != hipSuccess || per_cu < 1) fprintf(stderr, "kernel_launch: note: occupancy query reports %d\n", per_cu);
        (void)hipGetLastError();
        grid = cus;
        if (grid != 256) { fprintf(stderr, "kernel_launch: built for a 256-CU device, found %d CUs\n", cus); if (T % grid != 0 || T / grid > 128) { grid = -1; return; } }
    }
    if (grid < 0) return;
    if (hipMemsetAsync((char*)d_ws + WS_CTL, 0, CTL_ZERO_BYTES, stream) != hipSuccess) { fprintf(stderr, "kernel_launch: memset failed\n"); return; }
    Args a{};
    for (int i = 0; i < 25; ++i) a.in[i] = (const float*)d_in[i];
    a.out = (float*)d_out; a.ws = (unsigned char*)d_ws;
    for (int li = 0; li < N_LAUNCHES; ++li) {
        a.ph_lo = (N_LAUNCHES == 1) ? 0 : li; a.ph_hi = (N_LAUNCHES == 1) ? N_PHASES : li + 1; a.li = li;
        hipLaunchKernelGGL(mk_fwd, dim3(grid), dim3(NTHREADS), LDS_BYTES, stream, a);
        const hipError_t le = hipPeekAtLastError();
        if (le != hipSuccess) { fprintf(stderr, "kernel_launch: launch %d failed: %s\n", li, hipGetErrorName(le)); break; }
    }
}
```
